# Optimizing an MI355X kernel written in HIP

```python
import jax, jax.numpy as jnp
from jax import lax
import numpy as np

D_MODEL = 1024
BATCH = 8
SEQ = 2048
DEPTH = 4
DEC_BATCH = 128
DEC_SEQ = 1
PAST_LEN = 16384
PAGE_SIZE = 128

D_A = D_MODEL
CHUNK = 128
GW_A = 128
G_A = D_A // GW_A
D_B = D_MODEL
H_B = 16
BW_B = D_B // H_B
CONV_W = 4
C_RG = 8.0
EPS = 1e-6
SPLIT_SIZES = (D_A, D_A, D_A, D_B, D_B, D_MODEL, D_MODEL)
SPLIT_IDX = tuple(int(s) for s in np.cumsum(SPLIT_SIZES)[:-1])
D_IN = int(sum(SPLIT_SIZES))

kernel_name = "hybrid_gmlp_rglru_decoder_step"


def rmsnorm(x, g):
    xf = x.astype(jnp.float32)
    r = xf * lax.rsqrt(jnp.mean(xf * xf, axis=-1, keepdims=True) + EPS)
    return (r * g.astype(jnp.float32)).astype(x.dtype)


def chunk_spatial_gate(u, v, w_s, b_s):
    B, T, _ = v.shape
    n_chunks = -(-T // CHUNK)
    pad = n_chunks * CHUNK - T
    vp = jnp.pad(v, ((0, 0), (0, pad), (0, 0))).reshape(B, n_chunks, CHUNK, G_A, GW_A)
    mask = jnp.tril(jnp.ones((CHUNK, CHUNK), dtype=bool))
    ws = jnp.where(mask[None], w_s, jnp.zeros_like(w_s))
    s = jnp.einsum('gts,bnsgc->bntgc', ws, vp) + b_s.T[None, None, :, :, None]
    s = s.reshape(B, n_chunks * CHUNK, D_A)[:, :T]
    return u * s


def causal_conv(x, buf, conv_w, conv_b):
    T = x.shape[1]
    xp = jnp.concatenate([buf.astype(x.dtype), x], axis=1)
    out = conv_b
    for k in range(CONV_W):
        out = out + conv_w[k] * xp[:, k:k + T]
    return out, xp[:, -(CONV_W - 1):]


def rg_lru(x, h0, w_a, b_a, w_x, b_x, lam):
    B, T, _ = x.shape
    xh = x.reshape(B, T, H_B, BW_B)
    r = jax.nn.sigmoid(jnp.einsum('bthi,hij->bthj', xh, w_a).reshape(B, T, D_B) + b_a)
    i = jax.nn.sigmoid(jnp.einsum('bthi,hij->bthj', xh, w_x).reshape(B, T, D_B) + b_x)
    log_a = -C_RG * r.astype(jnp.float32) * jax.nn.softplus(-lam.astype(jnp.float32))
    a = jnp.exp(log_a)
    xs = jnp.sqrt(-jnp.expm1(2.0 * log_a)) * (i * x).astype(jnp.float32)

    def step(h, inp):
        a_t, x_t = inp
        h = a_t * h + x_t
        return h, h

    h_last, hs = lax.scan(step, h0.astype(jnp.float32),
                          (jnp.swapaxes(a, 0, 1), jnp.swapaxes(xs, 0, 1)))
    return jnp.swapaxes(hs, 0, 1).astype(x.dtype), h_last


def mixer_layer(x, c, h0, conv_buf, w_ada, b_ada, norm_g, w_in, v_norm_g, w_s, b_s,
                conv_w, conv_b, w_rg_a, b_rg_a, w_rg_x, b_rg_x, lam, w_pa, w_pb, w_out):
    mod = jax.nn.silu(c) @ w_ada + b_ada
    shift, scale, gate = jnp.split(mod, 3, axis=-1)
    h = rmsnorm(x, norm_g) * (1.0 + scale[:, None]) + shift[:, None]
    z = h @ w_in
    u, v, g_a, x_b, g_b, z_a, z_b = jnp.split(z, SPLIT_IDX, axis=-1)
    v = rmsnorm(v, v_norm_g)
    y_a = chunk_spatial_gate(u, v, w_s, b_s) * jax.nn.silu(g_a)
    xc, conv_new = causal_conv(x_b, conv_buf, conv_w, conv_b)
    y_rnn, h_last = rg_lru(xc, h0, w_rg_a, b_rg_a, w_rg_x, b_rg_x, lam)
    y_b = y_rnn * jax.nn.silu(g_b)
    merged = jax.nn.sigmoid(z_a) * (y_a @ w_pa) + jax.nn.sigmoid(z_b) * (y_b @ w_pb)
    out = x + gate[:, None] * (merged @ w_out)
    return out, h_last, conv_new, v


def setup_inputs(seed: int = 0) -> dict:
    key = jax.random.key(seed)
    ks = jax.random.split(key, 24)
    f32 = jnp.float32
    n = lambda k, shape, s: jax.random.normal(k, shape, f32) * s
    a0 = jax.random.uniform(ks[19], (DEPTH, D_B), f32, 0.9, 0.999)
    p = a0 ** (1.0 / C_RG)
    lam = jnp.log(p) - jnp.log1p(-p)
    return {
        "x_prompt": n(ks[0], (BATCH, SEQ, D_MODEL), 1.0),
        "x_sample": n(ks[1], (DEC_BATCH, DEC_SEQ, D_MODEL), 1.0),
        "c_prompt": n(ks[2], (BATCH, D_MODEL), 1.0),
        "c_sample": n(ks[3], (DEC_BATCH, D_MODEL), 1.0),
        "state_rglru_h": n(ks[4], (DEPTH, DEC_BATCH, D_B), 0.5),
        "state_conv": n(ks[5], (DEPTH, DEC_BATCH, CONV_W - 1, D_B), 1.0),
        "w_ada": n(ks[6], (DEPTH, D_MODEL, 3 * D_MODEL), 0.5 * D_MODEL ** -0.5),
        "b_ada": n(ks[7], (DEPTH, 3 * D_MODEL), 0.01),
        "norm_g": 1.0 + n(ks[8], (DEPTH, D_MODEL), 0.05),
        "w_in": n(ks[9], (DEPTH, D_MODEL, D_IN), D_MODEL ** -0.5),
        "v_norm_g": 1.0 + n(ks[10], (DEPTH, D_A), 0.05),
        "w_s": n(ks[11], (DEPTH, G_A, CHUNK, CHUNK), CHUNK ** -0.5),
        "b_s": 1.0 + n(ks[12], (DEPTH, G_A, CHUNK), 0.1),
        "conv_w": n(ks[13], (DEPTH, CONV_W, D_B), CONV_W ** -0.5),
        "conv_b": n(ks[14], (DEPTH, D_B), 0.01),
        "w_rg_a": n(ks[15], (DEPTH, H_B, BW_B, BW_B), BW_B ** -0.5),
        "b_rg_a": n(ks[16], (DEPTH, D_B), 0.01),
        "w_rg_x": n(ks[17], (DEPTH, H_B, BW_B, BW_B), BW_B ** -0.5),
        "b_rg_x": n(ks[18], (DEPTH, D_B), 0.01),
        "lam": lam,
        "w_pa": n(ks[20], (DEPTH, D_A, D_MODEL), D_A ** -0.5),
        "w_pb": n(ks[21], (DEPTH, D_B, D_MODEL), D_B ** -0.5),
        "w_out": n(ks[22], (DEPTH, D_MODEL, D_MODEL), D_MODEL ** -0.5),
        "final_g": 1.0 + n(ks[23], (D_MODEL,), 0.05),
    }


def reference(x_prompt, x_sample, c_prompt, c_sample, state_rglru_h, state_conv,
              w_ada, b_ada, norm_g, w_in, v_norm_g, w_s, b_s, conv_w, conv_b,
              w_rg_a, b_rg_a, w_rg_x, b_rg_x, lam, w_pa, w_pb, w_out, final_g):
    xp, xs = x_prompt, x_sample
    hp_list, cp_list, hs_list, cs_list, vs_list = [], [], [], [], []
    for l in range(DEPTH):
        params = (w_ada[l], b_ada[l], norm_g[l], w_in[l], v_norm_g[l], w_s[l], b_s[l],
                  conv_w[l], conv_b[l], w_rg_a[l], b_rg_a[l], w_rg_x[l], b_rg_x[l],
                  lam[l], w_pa[l], w_pb[l], w_out[l])
        h0_p = jnp.zeros((xp.shape[0], D_B), jnp.float32)
        buf_p = jnp.zeros((xp.shape[0], CONV_W - 1, D_B), xp.dtype)
        xp, hp, cp, _ = mixer_layer(xp, c_prompt, h0_p, buf_p, *params)
        xs, hs, cs, vs = mixer_layer(xs, c_sample, state_rglru_h[l], state_conv[l], *params)
        hp_list.append(hp)
        cp_list.append(cp)
        hs_list.append(hs)
        cs_list.append(cs)
        vs_list.append(vs)
    y_prompt = rmsnorm(xp, final_g)
    y_sample = rmsnorm(xs, final_g)
    h_prompt = jnp.stack(hp_list)
    conv_prompt = jnp.stack(cp_list)
    h_sample = jnp.stack(hs_list)
    conv_sample = jnp.stack(cs_list)
    chunk_v_sample = jnp.stack(vs_list)
    return (y_prompt, y_sample, h_prompt, conv_prompt, h_sample, conv_sample, chunk_v_sample)
```

```cpp
#include <hip/hip_runtime.h>
#include <cstdio>
#include <cstdint>

namespace pg8 {
#define PG8_LAS __attribute__((address_space(3)))
typedef unsigned short bf16_t;
typedef short bf16x8 __attribute__((ext_vector_type(8)));
typedef float f32x4 __attribute__((ext_vector_type(4)));
typedef unsigned u32x4 __attribute__((ext_vector_type(4)));
constexpr int BM = 256, BK = 64, HALF = 128, HTB = HALF * BK * 2  , STAGE_BYTES = 8 * HTB, NXCD = 8, WGM = 8;

__host__ __device__ __forceinline__ int lds_byte(int r, int c) { const int st = (r >> 4) * 2 + (c >> 5), rr = r & 15, cc = c & 31, ob = rr * 64 + cc * 2; return st * 1024 + (ob ^ (((ob >> 9) & 1) << 5)); }
__host__ __device__ __forceinline__ void stage_rc(int b, int& R, int& C) { const int st = b / 1024, sb = b % 1024, swz = sb ^ (((sb >> 9) & 1) << 5); R = (st >> 1) * 16 + swz / 64; C = (st & 1) * 32 + (swz % 64) / 2; }
__host__ __device__ __forceinline__ int perm32(int rho) { const int n = rho >> 4, i = rho & 15; return 8 * (i >> 2) + 4 * n + (i & 3); }

struct Unit { int pm, pn; };
struct Gemm { const bf16_t* A; const bf16_t* Bt; int M, N, K; };

struct StaticOrder {
    int nM, nN, nwg, G, c;
    __host__ __device__ void init(int M, int N, int G_, int c_) { nM = M / BM; nN = N / BM; nwg = nM * nN; G = G_; c = c_; }
    __host__ __device__ bool next(int i, Unit& u) const {
        const long L = (long)i * G + c; if (L >= nwg) return false;
        int wgid = (int)L; { const int q = nwg / NXCD, r = nwg % NXCD, xcd = wgid % NXCD, off = wgid / NXCD; wgid = (xcd < r ? xcd * (q + 1) : r * (q + 1) + (xcd - r) * q) + off; }
        const int nig = WGM * nN, gid = wgid / nig, fm = gid * WGM, gsz = (nM - fm) < WGM ? (nM - fm) : WGM;
        u.pm = fm + ((wgid % nig) % gsz); u.pn = (wgid % nig) / gsz; return true;
    }
    __device__ __forceinline__ void a_ready(const Unit&) const {}
    __device__ __forceinline__ void done(const Unit&) const {}
};


typedef __bf16 bf16x2_t __attribute__((ext_vector_type(2)));
typedef float f32x2_t __attribute__((ext_vector_type(2)));
__device__ __forceinline__ unsigned cvt_pk_bf16(float lo, float hi) { const f32x2_t v = {lo, hi}; return __builtin_bit_cast(unsigned, __builtin_convertvector(v, bf16x2_t)); }
__device__ __forceinline__ float bf_lo(unsigned w) { return __builtin_bit_cast(float, w << 16); }
__device__ __forceinline__ float bf_hi(unsigned w) { return __builtin_bit_cast(float, w & 0xffff0000u); }
__device__ __forceinline__ float sigmoid_f(float x) { return __builtin_amdgcn_rcpf(1.0f + __expf(-x)); }
__device__ __forceinline__ float silu_f(float x) { return x * sigmoid_f(x); }

struct Epi1 {
    static constexpr bool PERM = true, AFTER_DRAIN = false;
    bf16_t* Z; size_t zstride; float* vss;
    template <int ACT>
    __device__ __forceinline__ void tile(const f32x4 (&acc)[2][2][4][2], bf16_t* base, float* vs, int row0, int col0) const {
#pragma unroll
        for (int ai = 0; ai < 2; ++ai)
#pragma unroll
            for (int m = 0; m < 4; ++m) { const int row = row0 + ai * HALF + m * 16; bf16_t* rowp = base + (size_t)row * 1024 + col0; float ss = 0.f;
#pragma unroll
                for (int bj = 0; bj < 2; ++bj) { f32x4 v0 = acc[ai][bj][m][0], v1 = acc[ai][bj][m][1];
                    if (ACT == 3) ss += (v0[0] * v0[0] + v0[1] * v0[1]) + (v0[2] * v0[2] + v0[3] * v0[3]) + (v1[0] * v1[0] + v1[1] * v1[1]) + (v1[2] * v1[2] + v1[3] * v1[3]);
                    if (ACT == 1) {
#pragma unroll
                        for (int e = 0; e < 4; ++e) { v0[e] = silu_f(v0[e]); v1[e] = silu_f(v1[e]); } }
                    if (ACT == 2) {
#pragma unroll
                        for (int e = 0; e < 4; ++e) { v0[e] = sigmoid_f(v0[e]); v1[e] = sigmoid_f(v1[e]); } }
                    u32x4 w; w.x = cvt_pk_bf16(v0[0], v0[1]); w.y = cvt_pk_bf16(v0[2], v0[3]); w.z = cvt_pk_bf16(v1[0], v1[1]); w.w = cvt_pk_bf16(v1[2], v1[3]);
                    *(u32x4*)(rowp + bj * HALF) = w; }
                if (ACT == 3) { ss += __shfl_xor(ss, 16); ss += __shfl_xor(ss, 32); if (vs) vs[(size_t)row * 16] = ss; }
            }
    }
    __device__ __forceinline__ void operator()(const f32x4 (&acc)[2][2][4][2], const Unit& u, int wr, int wc, int fr, int fq) const {
        const int split = u.pn >> 2, colt = (u.pn & 3) * BM;
        bf16_t* base = Z + (size_t)split * zstride;
        const int row0 = u.pm * BM + wr * 64 + fr, col0 = colt + wc * 32 + 8 * fq;
        if (split == 1) tile<3>(acc, base, fq == 0 ? vss + (u.pn & 3) * 4 + wc : nullptr, row0, col0);
        else if (split == 2 || split == 4) tile<1>(acc, base, nullptr, row0, col0);
        else if (split >= 5) tile<2>(acc, base, nullptr, row0, col0);
        else tile<0>(acc, base, nullptr, row0, col0);
    }
};
template <bool SECOND> struct Epi2 {
    static constexpr bool PERM = true, AFTER_DRAIN = false;
    const bf16_t* S; bf16_t* T;
    __device__ __forceinline__ void operator()(const f32x4 (&acc)[2][2][4][2], const Unit& u, int wr, int wc, int fr, int fq) const {
        const int row0 = u.pm * BM + wr * 64 + fr, col0 = u.pn * BM + wc * 32 + 8 * fq;
#pragma unroll
        for (int ai = 0; ai < 2; ++ai)
#pragma unroll
            for (int m = 0; m < 4; ++m) { const size_t off = (size_t)(row0 + ai * HALF + m * 16) * 1024 + col0;
#pragma unroll
                for (int bj = 0; bj < 2; ++bj) { const f32x4 v0 = acc[ai][bj][m][0], v1 = acc[ai][bj][m][1];
                    const u32x4 s = *(const u32x4*)(S + off + bj * HALF);
                    float o[8] = {v0[0] * bf_lo(s.x), v0[1] * bf_hi(s.x), v0[2] * bf_lo(s.y), v0[3] * bf_hi(s.y), v1[0] * bf_lo(s.z), v1[1] * bf_hi(s.z), v1[2] * bf_lo(s.w), v1[3] * bf_hi(s.w)};
                    if (SECOND) { const u32x4 t = *(const u32x4*)(T + off + bj * HALF);
                        o[0] += bf_lo(t.x); o[1] += bf_hi(t.x); o[2] += bf_lo(t.y); o[3] += bf_hi(t.y); o[4] += bf_lo(t.z); o[5] += bf_hi(t.z); o[6] += bf_lo(t.w); o[7] += bf_hi(t.w); }
                    u32x4 w; w.x = cvt_pk_bf16(o[0], o[1]); w.y = cvt_pk_bf16(o[2], o[3]); w.z = cvt_pk_bf16(o[4], o[5]); w.w = cvt_pk_bf16(o[6], o[7]);
                    *(u32x4*)(T + off + bj * HALF) = w; }
                asm volatile("" ::: "memory"); }
    }
};
struct Epi3 {
    static constexpr bool PERM = false, AFTER_DRAIN = false;
    const float* base; float* out; const float* gate;
    __device__ __forceinline__ void operator()(const f32x4 (&acc)[2][2][4][2], const Unit& u, int wr, int wc, int fr, int fq) const {
        const int row0 = u.pm * BM + wr * 64 + fr, col0 = u.pn * BM + wc * 32 + 4 * fq;
        const float* gp = gate + (size_t)(u.pm >> 3) * 3072 + col0;
        f32x4 gv[2][2];
#pragma unroll
        for (int bj = 0; bj < 2; ++bj)
#pragma unroll
            for (int n = 0; n < 2; ++n) gv[bj][n] = *(const f32x4*)(gp + bj * HALF + n * 16);
#pragma unroll
        for (int ai = 0; ai < 2; ++ai)
#pragma unroll
            for (int m = 0; m < 4; ++m) { const size_t off = (size_t)(row0 + ai * HALF + m * 16) * 1024 + col0;
#pragma unroll
                for (int bj = 0; bj < 2; ++bj)
#pragma unroll
                    for (int n = 0; n < 2; ++n) { const f32x4 bs = *(const f32x4*)(base + off + bj * HALF + n * 16);
                        *(f32x4*)(out + off + bj * HALF + n * 16) = bs + gv[bj][n] * acc[ai][bj][m][n]; }
                if (m & 1) asm volatile("" ::: "memory"); }
    }
};


template <class Epi, class Sched, bool ALIGN_EPI = false, bool SP2 = false>
__device__ __forceinline__ void gemm_phase(PG8_LAS unsigned char* lds, const Gemm g, const Sched& S, const Epi& E) {
    int tid_ = threadIdx.x; asm volatile("" : "+v"(tid_));
    const int tid = tid_, wid = __builtin_amdgcn_readfirstlane(tid >> 6), lane = tid & 63, wr = wid >> 2, wc = wid & 3, fr = lane & 15, fq = lane >> 4;
    const int K = g.K, nt = K / BK;
    unsigned voffA[2], voffB[2];
#pragma unroll
    for (int i = 0; i < 2; ++i) { int R, C; stage_rc(tid * 16 + i * 8192, R, C); const int Rb = Epi::PERM ? ((R & ~31) + perm32(R & 31)) : R;
        voffA[i] = (unsigned)(R * K + C) * 2u; voffB[i] = (unsigned)(Rb * K + C) * 2u; }
    const size_t kstep = (size_t)(BK * 2);
    const size_t hstep = (size_t)HALF * K * 2;
    const size_t tstep = 2 * hstep;
    const unsigned ldsw = (unsigned)wid * 1024u;
    const int aoff = lds_byte(wr * 64 + fr, fq * 8), boff = lds_byte(wc * 32 + fr, fq * 8);
#define PG8_SA(b, h) (((b) * 2 + (h)) * HTB)
#define PG8_SB(b, h) ((4 + (b) * 2 + (h)) * HTB)
#define PG8_STAGE(bufoff, gbase, voff) do { _Pragma("unroll") for (int _i = 0; _i < 2; ++_i) \
        __builtin_amdgcn_global_load_lds((const unsigned*)((const char*)(gbase) + (voff)[_i]), (PG8_LAS unsigned*)(lds + (bufoff) + ldsw + _i * 8192), 16, 0, 0); } while (0)
#define PG8_LDA(dst, b, h) do { _Pragma("unroll") for (int m = 0; m < 4; ++m) _Pragma("unroll") for (int k = 0; k < 2; ++k) dst[m][k] = *(const PG8_LAS bf16x8*)(lds + PG8_SA(b, h) + aoff + m * 2048 + k * 1024); } while (0)
#define PG8_LDB(dst, b, h) do { _Pragma("unroll") for (int n = 0; n < 2; ++n) _Pragma("unroll") for (int k = 0; k < 2; ++k) dst[n][k] = *(const PG8_LAS bf16x8*)(lds + PG8_SB(b, h) + boff + n * 2048 + k * 1024); } while (0)
#define PG8_MMA(ai, bj, At, Bt) do { __builtin_amdgcn_s_setprio(1); _Pragma("unroll") for (int m = 0; m < 4; ++m) _Pragma("unroll") for (int n = 0; n < 2; ++n) _Pragma("unroll") for (int k = 0; k < 2; ++k) \
        acc[ai][bj][m][n] = __builtin_amdgcn_mfma_f32_16x16x32_bf16(Bt[n][k], At[m][k], acc[ai][bj][m][n], 0, 0, 0); __builtin_amdgcn_s_setprio(0); } while (0)
#define PG8_WAIT_V(n) asm volatile("s_waitcnt vmcnt(" #n ")" ::: "memory")
#define PG8_WAIT_L(n) asm volatile("s_waitcnt lgkmcnt(" #n ")" ::: "memory")
#define PG8_BAR __builtin_amdgcn_s_barrier()
#define PG8_SCHED __builtin_amdgcn_sched_barrier(0)
    Unit cur, nxt; int ui = 0;
    if (!S.next(0, cur)) return;
    f32x4 acc[2][2][4][2];
#pragma unroll
    for (int a = 0; a < 2; ++a)
#pragma unroll
        for (int b = 0; b < 2; ++b)
#pragma unroll
            for (int m = 0; m < 4; ++m)
#pragma unroll
                for (int n = 0; n < 2; ++n) acc[a][b][m][n] = (f32x4){0.f, 0.f, 0.f, 0.f};
    bf16x8 At[4][2], B0[2][2], B1[2][2];
    const char* cA = (const char*)g.A + (size_t)cur.pm * tstep; const char* cB = (const char*)g.Bt + (size_t)cur.pn * tstep;
    S.a_ready(cur);
    if constexpr (SP2) {
        PG8_STAGE(PG8_SB(0, 0), cB, voffB); PG8_STAGE(PG8_SB(0, 1), cB + hstep, voffB); PG8_STAGE(PG8_SA(0, 0), cA, voffA); PG8_STAGE(PG8_SA(0, 1), cA + hstep, voffA);
        if (wr == 1) PG8_BAR;
        PG8_WAIT_V(2); PG8_BAR;
        PG8_STAGE(PG8_SB(1, 0), cB + kstep, voffB); PG8_STAGE(PG8_SA(1, 0), cA + kstep, voffA); PG8_STAGE(PG8_SB(1, 1), cB + hstep + kstep, voffB);
        PG8_WAIT_V(6); PG8_BAR;
    } else {
        PG8_STAGE(PG8_SB(0, 0), cB, voffB); PG8_STAGE(PG8_SA(0, 0), cA, voffA); PG8_STAGE(PG8_SB(0, 1), cB + hstep, voffB); PG8_STAGE(PG8_SA(0, 1), cA + hstep, voffA);
        if (wr == 1) PG8_BAR;
        PG8_WAIT_V(4); PG8_BAR;
        PG8_STAGE(PG8_SB(1, 0), cB + kstep, voffB); PG8_STAGE(PG8_SA(1, 0), cA + kstep, voffA); PG8_STAGE(PG8_SB(1, 1), cB + hstep + kstep, voffB);
        PG8_WAIT_V(6); PG8_BAR;
    }
    for (;;) {
        const bool has_next = S.next(ui + 1, nxt);
        const char* nA = has_next ? (const char*)g.A + (size_t)nxt.pm * tstep : cA; const char* nB = has_next ? (const char*)g.Bt + (size_t)nxt.pn * tstep : cB;
        for (int t = 0; t < nt; t += 2) {
            const bool last = (t == nt - 2);
            const char* a1 = cA + (size_t)(t + 1) * kstep;
            const char* a2 = last ? nA : cA + (size_t)(t + 2) * kstep; const char* b2 = last ? nB : cB + (size_t)(t + 2) * kstep;
            const char* a3 = a2 + kstep; const char* b3 = b2 + kstep;
            if (last && has_next) S.a_ready(nxt);
            if constexpr (SP2) {
            PG8_LDB(B0, 0, 0); PG8_LDB(B1, 0, 1); PG8_SCHED; PG8_LDA(At, 0, 0); PG8_STAGE(PG8_SA(1, 1), a1 + hstep, voffA);
            PG8_WAIT_V(8); PG8_WAIT_L(0); PG8_BAR; PG8_MMA(0, 0, At, B0); PG8_MMA(0, 1, At, B1); PG8_BAR; PG8_SCHED;
            PG8_LDA(At, 0, 1); PG8_STAGE(PG8_SB(0, 0), b2, voffB); PG8_STAGE(PG8_SB(0, 1), b2 + hstep, voffB); PG8_STAGE(PG8_SA(0, 0), a2, voffA);
            PG8_WAIT_V(8); PG8_WAIT_L(0); PG8_BAR; PG8_MMA(1, 0, At, B0); PG8_MMA(1, 1, At, B1); PG8_BAR; PG8_SCHED;
            PG8_LDB(B0, 1, 0); PG8_LDB(B1, 1, 1); PG8_SCHED; PG8_LDA(At, 1, 0); PG8_STAGE(PG8_SA(0, 1), a2 + hstep, voffA);
            PG8_WAIT_V(8); PG8_WAIT_L(0); PG8_BAR; PG8_MMA(0, 0, At, B0); PG8_MMA(0, 1, At, B1); PG8_BAR; PG8_SCHED;
            PG8_LDA(At, 1, 1); PG8_STAGE(PG8_SB(1, 0), b3, voffB); PG8_STAGE(PG8_SB(1, 1), b3 + hstep, voffB); PG8_STAGE(PG8_SA(1, 0), a3, voffA);
            PG8_WAIT_V(8); PG8_WAIT_L(0); PG8_BAR; PG8_MMA(1, 0, At, B0); PG8_MMA(1, 1, At, B1); PG8_BAR; PG8_SCHED;
            } else {
            PG8_LDB(B0, 0, 0); PG8_SCHED; PG8_LDA(At, 0, 0); PG8_STAGE(PG8_SA(1, 1), a1 + hstep, voffA);
            PG8_WAIT_L(8); PG8_BAR; PG8_WAIT_L(0); PG8_MMA(0, 0, At, B0); PG8_BAR; PG8_SCHED;
            PG8_LDB(B1, 0, 1); PG8_STAGE(PG8_SB(0, 0), b2, voffB);
            PG8_BAR; PG8_WAIT_L(0); PG8_MMA(0, 1, At, B1); PG8_BAR;
            PG8_LDA(At, 0, 1); PG8_STAGE(PG8_SA(0, 0), a2, voffA);
            PG8_BAR; PG8_WAIT_L(0); PG8_MMA(1, 0, At, B0); PG8_BAR; PG8_SCHED;
            PG8_STAGE(PG8_SB(0, 1), b2 + hstep, voffB);
            PG8_WAIT_V(6); PG8_BAR; PG8_MMA(1, 1, At, B1); PG8_BAR;
            PG8_LDB(B0, 1, 0); PG8_SCHED; PG8_LDA(At, 1, 0); PG8_STAGE(PG8_SA(0, 1), a2 + hstep, voffA);
            PG8_WAIT_L(8); PG8_BAR; PG8_WAIT_L(0); PG8_MMA(0, 0, At, B0); PG8_BAR; PG8_SCHED;
            PG8_LDB(B1, 1, 1); PG8_STAGE(PG8_SB(1, 0), b3, voffB);
            PG8_BAR; PG8_WAIT_L(0); PG8_MMA(0, 1, At, B1); PG8_BAR;
            PG8_LDA(At, 1, 1); PG8_STAGE(PG8_SA(1, 0), a3, voffA);
            PG8_BAR; PG8_WAIT_L(0); PG8_MMA(1, 0, At, B0); PG8_BAR; PG8_SCHED;
            PG8_STAGE(PG8_SB(1, 1), b3 + hstep, voffB);
            PG8_WAIT_V(6); PG8_BAR; PG8_MMA(1, 1, At, B1); PG8_BAR;
            }
        }
        if constexpr (ALIGN_EPI) { if (wr == 0) PG8_BAR; }
        if constexpr (!Epi::AFTER_DRAIN) { E(acc, cur, wr, wc, fr, fq); S.done(cur); }
        if (!has_next) break;
#pragma unroll
        for (int a = 0; a < 2; ++a)
#pragma unroll
            for (int b = 0; b < 2; ++b)
#pragma unroll
                for (int m = 0; m < 4; ++m)
#pragma unroll
                    for (int n = 0; n < 2; ++n) acc[a][b][m][n] = (f32x4){0.f, 0.f, 0.f, 0.f};
        cur = nxt; cA = nA; cB = nB; ++ui;
        if constexpr (ALIGN_EPI) { if (wr == 1) PG8_BAR; }
    }
    PG8_WAIT_V(0);
    if constexpr (!ALIGN_EPI) { if (wr == 0) PG8_BAR; }
    PG8_BAR;
    if constexpr (Epi::AFTER_DRAIN) { E.fused(acc, cur, wr, wc, fr, fq, lds, wid, lane); S.done(cur); }
#undef PG8_SA
#undef PG8_SB
#undef PG8_STAGE
#undef PG8_LDA
#undef PG8_LDB
#undef PG8_MMA
#undef PG8_WAIT_V
#undef PG8_WAIT_L
#undef PG8_BAR
#undef PG8_SCHED
}
}

#ifndef PG8_SP2
#define PG8_SP2 true
#endif
#ifndef PG8_ALIGN
#define PG8_ALIGN true
#endif


constexpr int NWAVES = 8;
#ifndef MK_ONE_LAUNCH
#define MK_ONE_LAUNCH 0
#endif

constexpr int D = 1024, NB = 8, T = 2048, MP = NB * T  , NS = 128  , DEPTH = 4, DIN = 7 * D, NBS = NB + NS  ;
constexpr int CHUNK = 128, NCH = T / CHUNK;
constexpr float EPS = 1e-6f;
constexpr int NPH = 2 + 5 * DEPTH + 1;

constexpr size_t MiB = 1u << 20;
constexpr size_t WS_CTL = 0, CTL_ZERO_BYTES = 1 * MiB;
constexpr size_t WS_WIN = 2 * MiB;
constexpr size_t WS_WPA = 58 * MiB, WS_WPB = 66 * MiB, WS_WOUT = 74 * MiB;
constexpr size_t WS_WADA = 82 * MiB;
constexpr size_t WS_MOD = 106 * MiB;
constexpr size_t WS_WSB = 114 * MiB;
constexpr size_t WS_WRA = 115 * MiB, WS_WRX = WS_WRA + 512 * 1024;
constexpr size_t WS_SC = 116 * MiB;
constexpr size_t WS_VSS = 117 * MiB;
constexpr size_t WS_ZS = 118 * MiB;
constexpr size_t WS_HS = 122 * MiB;
constexpr size_t WS_YAS = WS_HS + 256 * 1024, WS_YBS = WS_YAS + 256 * 1024, WS_MS = WS_YBS + 256 * 1024;
constexpr size_t WS_XS = 123 * MiB;
constexpr size_t WS_H = 128 * MiB;
constexpr size_t WS_Z = 160 * MiB;
constexpr size_t ZSTRIDE = (size_t)MP * D;
constexpr size_t WS_END = WS_Z + 7 * 32 * MiB;
constexpr int CW_BAR = 4096;

constexpr int RING_OFF = 0, RING_BYTES = 131072;
constexpr int LDSCTL_OFF = RING_BYTES, MISC_OFF = LDSCTL_OFF + 320;
constexpr int LDS_BYTES = 147456;


#define GAS __attribute__((address_space(1)))
#define LAS __attribute__((address_space(3)))
typedef unsigned short bf16;
typedef unsigned v4u __attribute__((ext_vector_type(4)));
typedef float f32x4 __attribute__((ext_vector_type(4)));
typedef short bf16x8 __attribute__((ext_vector_type(8)));
typedef GAS unsigned gu32;
typedef GAS unsigned long long gu64;
#define RLX_AGENT __ATOMIC_RELAXED, __HIP_MEMORY_SCOPE_AGENT
#define LDS_WAIT() asm volatile("s_waitcnt lgkmcnt(0)" ::: "memory")
#define VM_WAIT() asm volatile("s_waitcnt vmcnt(0)" ::: "memory")
__device__ __forceinline__ unsigned long long rt() { return __builtin_amdgcn_s_memrealtime(); }
__device__ __forceinline__ unsigned pk2(float lo, float hi) { return pg8::cvt_pk_bf16(lo, hi); }
__device__ __forceinline__ unsigned f2bf(float f) { return pg8::cvt_pk_bf16(f, 0.f) & 0xffffu; }

#define XB_TMO      128
#define XB_XCNT(j)  (256  + 64 * (j))
#define XB_XSUB(j)  (1280 + 64 * (j))
#define XB_XGEN(j)  (2304 + 64 * (j))
#define XB_TOP      3328
#define XB_TOPGEN   3392
#define XCD_BAR_WORDS 3456
#define XB_SPIN_CAP (1u << 18)

__device__ __forceinline__ unsigned xb_ld(unsigned* p)              { return __hip_atomic_load(p, __ATOMIC_RELAXED, __HIP_MEMORY_SCOPE_AGENT); }
__device__ __forceinline__ unsigned xb_add(unsigned* p, unsigned v) { return __hip_atomic_fetch_add(p, v, __ATOMIC_RELAXED, __HIP_MEMORY_SCOPE_AGENT); }
__device__ __forceinline__ unsigned xb_xcc_id() { return (unsigned)__builtin_amdgcn_s_getreg((3 << 11) | 20) & 0xFu; }
#define XB_SPIN(cond, bar) do { unsigned _sp = 0; while (cond) { __builtin_amdgcn_s_sleep(1); \
    if ((++_sp & 255u) == 0u) { if (xb_ld(&(bar)[XB_TMO])) break; if (_sp > XB_SPIN_CAP) { atomicAdd(&(bar)[XB_TMO], 1u); break; } } } } while (0)

struct XcdBarrier {
    unsigned* bar; unsigned x;
    volatile LAS unsigned* st;
};

__device__ __forceinline__ XcdBarrier xcd_barrier_post(unsigned* bar, volatile LAS unsigned* st) {
    XcdBarrier b; b.bar = bar; b.x = xb_xcc_id(); b.st = st;
    if (threadIdx.x == 0) (void)xb_add(&bar[XB_XCNT(b.x)], 1u);
    return b;
}
__device__ __forceinline__ void xcd_barrier_complete(unsigned* bar, unsigned x, unsigned& nloc, unsigned& nx) {
    const unsigned G = gridDim.x * gridDim.y * gridDim.z;
    unsigned sum, cnt, mine, sp = 0u;
    for (;;) {
        sum = 0u; cnt = 0u; mine = 0u;
#pragma unroll
        for (unsigned j = 0; j < 16; ++j) { const unsigned c = xb_ld(&bar[XB_XCNT(j)]); sum += c; cnt += (c > 0u) ? 1u : 0u; mine = (j == x) ? c : mine; }
        if (sum == G) break;
        __builtin_amdgcn_s_sleep(1);
        if ((++sp & 255u) == 0u) { if (xb_ld(&bar[XB_TMO])) break; if (sp > XB_SPIN_CAP) { atomicAdd(&bar[XB_TMO], 1u); break; } }
    }
    nloc = mine > 0u ? mine : 1u; nx = cnt > 0u ? cnt : 1u;
}

__device__ __forceinline__ void xcd_barrier(const XcdBarrier& b) {
    asm volatile("s_waitcnt vmcnt(0)" ::: "memory");
    __syncthreads();
    if (threadIdx.x == 0) {
        unsigned* bar = b.bar;
        __builtin_amdgcn_s_waitcnt(0);
        unsigned nloc = b.st[0], nx = b.st[1];
        if (nloc == 0u) { xcd_barrier_complete(bar, b.x, nloc, nx); b.st[0] = nloc; b.st[1] = nx; }
        const unsigned old = xb_add(&bar[XB_XSUB(b.x)], 1u);
        const unsigned gen = old / nloc;
        if (old + 1u == (gen + 1u) * nloc) {
            __builtin_amdgcn_fence(__ATOMIC_RELEASE, "agent");
            asm volatile("s_waitcnt vmcnt(0)" ::: "memory");
            const unsigned og = xb_add(&bar[XB_TOP], 1u);
            const unsigned tg = og / nx;
            if (og + 1u == (tg + 1u) * nx) xb_add(&bar[XB_TOPGEN], 1u);
            else XB_SPIN(xb_ld(&bar[XB_TOPGEN]) == tg, bar);
            __builtin_amdgcn_fence(__ATOMIC_ACQUIRE, "agent");
            xb_add(&bar[XB_XGEN(b.x)], 1u);
            asm volatile("s_waitcnt vmcnt(0)" ::: "memory");
        } else {
            XB_SPIN(xb_ld(&bar[XB_XGEN(b.x)]) == gen, bar);
            __builtin_amdgcn_fence(__ATOMIC_ACQUIRE, "agent");
            asm volatile("s_waitcnt vmcnt(0)" ::: "memory");
        }
    }
    __syncthreads();
}


typedef unsigned short u16x4v __attribute__((ext_vector_type(4)));
typedef short s16x4 __attribute__((ext_vector_type(4)));
typedef unsigned u32x2v __attribute__((ext_vector_type(2)));
typedef __attribute__((address_space(4))) const unsigned long long kq_t;
struct Frame {
    LAS unsigned char* lds;
    volatile LAS unsigned* MISC;
    int tid, lane, wave;
    int vcu, G;
    kq_t* ka;
    float* out; unsigned char* ws;
};
__device__ __forceinline__ const float* kin(const Frame& F, int i) { kq_t* k = F.ka; asm volatile("" : "+s"(k)); return (const float*)(const GAS float*)k[i]; }
__device__ __forceinline__ void phase_begin(Frame& F) { int t = threadIdx.x; asm volatile("" : "+v"(t)); F.tid = t; F.lane = t & 63; F.wave = __builtin_amdgcn_readfirstlane(t >> 6); }
__device__ __forceinline__ float wave_sum(float v) {
#pragma unroll
    for (int o = 1; o < 64; o <<= 1) v += __shfl_xor(v, o);
    return v;
}
__device__ __forceinline__ float bfl(unsigned w) { return __builtin_bit_cast(float, w << 16); }
__device__ __forceinline__ float bfh(unsigned w) { return __builtin_bit_cast(float, w & 0xffff0000u); }
__device__ __forceinline__ float bf1(bf16 h) { return __builtin_bit_cast(float, (unsigned)h << 16); }
__device__ __forceinline__ float sigm(float x) { return __builtin_amdgcn_rcpf(1.0f + __expf(-x)); }
__device__ __forceinline__ float siluf(float x) { return x * sigm(x); }

__device__ __forceinline__ void p0_transpose_item(const float* W, int K, int N, bf16* WT, LAS float* scr, int item, int lane) {
    const int nblk = N / 32, kb = item / nblk, nb = item % nblk, k0 = 64 * kb, n0 = 32 * nb;
#pragma unroll 8
    for (int i = 0; i < 32; ++i) { const int kk = 2 * i + (lane >> 5); scr[kk * 33 + (lane & 31)] = W[(size_t)(k0 + kk) * N + n0 + (lane & 31)]; }
    LDS_WAIT(); asm volatile("" ::: "memory");
    const int c = lane & 7;
#pragma unroll
    for (int j = 0; j < 4; ++j) { const int n = (lane >> 3) + 8 * j; const LAS float* s = scr + (8 * c) * 33 + n;
        v4u o; o.x = pk2(s[0 * 33], s[1 * 33]); o.y = pk2(s[2 * 33], s[3 * 33]); o.z = pk2(s[4 * 33], s[5 * 33]); o.w = pk2(s[6 * 33], s[7 * 33]);
        *(GAS v4u*)(WT + (size_t)(n0 + n) * K + k0 + 8 * c) = o; }
    LDS_WAIT(); asm volatile("" ::: "memory");
}

__device__ __forceinline__ void p0_convert(Frame& F) {
    phase_begin(F);
    LAS float* scr = (LAS float*)(F.lds + RING_OFF + F.wave * 16384);
    const int gw = F.vcu * NWAVES + F.wave, NGW = F.G * NWAVES;
    constexpr int I_IN = (D / 64) * (DIN / 32), I_SQ = (D / 64) * (D / 32), I_ADA = (D / 64) * (3 * D / 32);
    constexpr int PER_L = I_IN + 3 * I_SQ + I_ADA, NITEMS = DEPTH * PER_L;
    for (int it = gw; it < NITEMS; it += NGW) {
        const int l = it / PER_L; int r = it % PER_L;
        if (r < I_IN) { p0_transpose_item(kin(F, 9) + (size_t)l * D * DIN, D, DIN, (bf16*)(F.ws + WS_WIN) + (size_t)l * DIN * D, scr, r, F.lane); continue; } r -= I_IN;
        if (r < I_SQ) { p0_transpose_item(kin(F, 20) + (size_t)l * D * D, D, D, (bf16*)(F.ws + WS_WPA) + (size_t)l * D * D, scr, r, F.lane); continue; } r -= I_SQ;
        if (r < I_SQ) { p0_transpose_item(kin(F, 21) + (size_t)l * D * D, D, D, (bf16*)(F.ws + WS_WPB) + (size_t)l * D * D, scr, r, F.lane); continue; } r -= I_SQ;
        if (r < I_SQ) { p0_transpose_item(kin(F, 22) + (size_t)l * D * D, D, D, (bf16*)(F.ws + WS_WOUT) + (size_t)l * D * D, scr, r, F.lane); continue; } r -= I_SQ;
        p0_transpose_item(kin(F, 6) + (size_t)l * D * 3 * D, D, 3 * D, (bf16*)(F.ws + WS_WADA) + (size_t)l * 3 * D * D, scr, r, F.lane);
    }
    const int gt = F.vcu * (NWAVES * 64) + F.tid, NGT = F.G * NWAVES * 64;
    {
        const float* ws_ = kin(F, 11); bf16* o = (bf16*)(F.ws + WS_WSB);
        for (int e = gt; e < DEPTH * 8 * 128 * 128; e += NGT) { const int s = e & 127, t = (e >> 7) & 127; o[e] = (bf16)(s <= t ? f2bf(ws_[e]) : 0u); }
    }
    {
        const float* wa = kin(F, 15); const float* wx = kin(F, 17); bf16* oa = (bf16*)(F.ws + WS_WRA); bf16* ox = (bf16*)(F.ws + WS_WRX);
        for (int e = gt; e < DEPTH * 16 * 64 * 64; e += NGT) { const int i = e & 63, j = (e >> 6) & 63, lh = e >> 12; const int src = (lh << 12) + (i << 6) + j;
            oa[e] = (bf16)f2bf(wa[src]); ox[e] = (bf16)f2bf(wx[src]); }
    }
    {
        const float* cp = kin(F, 2); const float* cs = kin(F, 3); bf16* o = (bf16*)(F.ws + WS_SC);
        for (int e = gt; e < 160 * D; e += NGT) { const int r = e >> 10; float v = 0.f; if (r < NB) v = siluf(cp[e]); else if (r < NBS) v = siluf(cs[e - NB * D]); o[e] = (bf16)f2bf(v); }
    }
}

template <int RT, bool DUAL, class Epi>
__device__ __forceinline__ void skinny_gemm(Frame& F, const bf16* A, const bf16* Bt, const bf16* A2, const bf16* Bt2, int N, const Epi& E) {
    phase_begin(F);
    LAS float* red = (LAS float*)(F.lds + RING_OFF);
    const int lane = F.lane, fr = lane & 15, fq = lane >> 4, kb = F.wave * 128 + 8 * fq;
    for (int unit = F.vcu; unit < N / 16; unit += F.G) {
        const int n0 = unit * 16;
        pg8::f32x4 acc[RT], acc2[DUAL ? RT : 1];
#pragma unroll
        for (int r = 0; r < RT; ++r) acc[r] = (pg8::f32x4){0.f, 0.f, 0.f, 0.f};
        if (DUAL) {
#pragma unroll
            for (int r = 0; r < RT; ++r) acc2[r] = (pg8::f32x4){0.f, 0.f, 0.f, 0.f}; }
#pragma unroll 2
        for (int ks = 0; ks < 4; ++ks) {
            const bf16x8 bfr = *(const GAS bf16x8*)(Bt + (size_t)(n0 + fr) * D + kb + ks * 32);
#pragma unroll
            for (int r = 0; r < RT; ++r) { const bf16x8 afr = *(const GAS bf16x8*)(A + (size_t)(r * 16 + fr) * D + kb + ks * 32);
                acc[r] = __builtin_amdgcn_mfma_f32_16x16x32_bf16(afr, bfr, acc[r], 0, 0, 0); }
            if (DUAL) { const bf16x8 bfr2 = *(const GAS bf16x8*)(Bt2 + (size_t)(n0 + fr) * D + kb + ks * 32);
#pragma unroll
                for (int r = 0; r < RT; ++r) { const bf16x8 afr = *(const GAS bf16x8*)(A2 + (size_t)(r * 16 + fr) * D + kb + ks * 32);
                    acc2[r] = __builtin_amdgcn_mfma_f32_16x16x32_bf16(afr, bfr2, acc2[r], 0, 0, 0); } }
        }
#pragma unroll
        for (int r = 0; r < RT; ++r)
#pragma unroll
            for (int q = 0; q < 4; ++q) { red[((F.wave * RT + r) * 4 + q) * 64 + lane] = acc[r][q]; if (DUAL) red[8 * RT * 256 + ((F.wave * RT + r) * 4 + q) * 64 + lane] = acc2[r][q]; }
        __syncthreads();
        for (int e = F.tid; e < RT * 256; e += NWAVES * 64) { float s = 0.f, s2 = 0.f;
#pragma unroll
            for (int w = 0; w < 8; ++w) { s += red[w * RT * 256 + e]; if (DUAL) s2 += red[8 * RT * 256 + w * RT * 256 + e]; }
            const int ln = e & 63, q = (e >> 6) & 3, r = e >> 8; E(r * 16 + 4 * (ln >> 4) + q, n0 + (ln & 15), s, s2); }
        __syncthreads();
    }
}
struct EpiMod { float* mod; const float* b_ada;
    __device__ __forceinline__ void operator()(int row, int col, float s, float) const { if (row < NBS) { const int l = col / (3 * D), c = col % (3 * D); mod[((size_t)l * NBS + row) * 3 * D + c] = s + b_ada[col]; } } };
struct EpiZs { float* zs; __device__ __forceinline__ void operator()(int row, int col, float s, float) const { zs[(size_t)row * DIN + col] = s; } };
struct EpiMs { const float* zs; bf16* ms;
    __device__ __forceinline__ void operator()(int row, int col, float s, float s2) const { const float za = zs[(size_t)row * DIN + 5 * D + col], zb = zs[(size_t)row * DIN + 6 * D + col];
        ms[(size_t)row * D + col] = (bf16)f2bf(sigm(za) * s + sigm(zb) * s2); } };
struct EpiXs { const float* base; float* xs; const float* gate;
    __device__ __forceinline__ void operator()(int row, int col, float s, float) const { xs[(size_t)row * D + col] = base[(size_t)row * D + col] + gate[(size_t)row * 3 * D + col] * s; } };

__device__ __forceinline__ void norm_row(Frame& F, const float* xrow, const float* g, const float* modb, bf16* orow) {
    const GAS f32x4* xr = (const GAS f32x4*)xrow + F.lane;
    f32x4 v[4]; float s = 0.f;
#pragma unroll
    for (int j = 0; j < 4; ++j) { v[j] = xr[64 * j]; s += (v[j].x * v[j].x + v[j].y * v[j].y) + (v[j].z * v[j].z + v[j].w * v[j].w); }
    const float rinv = 1.0f / sqrtf(wave_sum(s) * (1.f / D) + EPS);
    GAS unsigned long long* o8 = (GAS unsigned long long*)orow + F.lane;
#pragma unroll
    for (int j = 0; j < 4; ++j) { const int c = 4 * F.lane + 256 * j; const f32x4 gg = *(const GAS f32x4*)(g + c), sh = *(const GAS f32x4*)(modb + c), sc = *(const GAS f32x4*)(modb + D + c);
        const f32x4 h = (v[j] * rinv) * gg * (sc + 1.0f) + sh;
        o8[64 * j] = (unsigned long long)pk2(h.x, h.y) | ((unsigned long long)pk2(h.z, h.w) << 32); }
}
__device__ __forceinline__ void p_norm(Frame& F, int l) {
    phase_begin(F);
    const int gw = F.vcu * NWAVES + F.wave, NGW = F.G * NWAVES;
    const float* xp = l == 0 ? kin(F, 0) : F.out; const float* xs = l == 0 ? kin(F, 1) : (const float*)(F.ws + WS_XS);
    const float* g = kin(F, 8) + l * D; const float* mod = (const float*)(F.ws + WS_MOD) + (size_t)l * NBS * 3 * D;
    for (int m = gw; m < MP + NS; m += NGW) {
        if (m < MP) norm_row(F, xp + (size_t)m * D, g, mod + (size_t)(m / T) * 3 * D, (bf16*)(F.ws + WS_H) + (size_t)m * D);
        else { const int s = m - MP; norm_row(F, xs + (size_t)s * D, g, mod + (size_t)(NB + s) * 3 * D, (bf16*)(F.ws + WS_HS) + (size_t)s * D); }
    }
}
__device__ __forceinline__ void final_row(Frame& F, const float* xrow, const float* g, float* orow) {
    const GAS f32x4* xr = (const GAS f32x4*)xrow + F.lane;
    f32x4 v[4]; float s = 0.f;
#pragma unroll
    for (int j = 0; j < 4; ++j) { v[j] = xr[64 * j]; s += (v[j].x * v[j].x + v[j].y * v[j].y) + (v[j].z * v[j].z + v[j].w * v[j].w); }
    const float rinv = 1.0f / sqrtf(wave_sum(s) * (1.f / D) + EPS);
    GAS f32x4* o = (GAS f32x4*)orow + F.lane;
#pragma unroll
    for (int j = 0; j < 4; ++j) { const f32x4 gg = *(const GAS f32x4*)(g + 4 * F.lane + 256 * j); o[64 * j] = (v[j] * rinv) * gg; }
}
__device__ __forceinline__ void p_final(Frame& F) {
    phase_begin(F);
    const int gw = F.vcu * NWAVES + F.wave, NGW = F.G * NWAVES;
    for (int m = gw; m < MP + NS; m += NGW) {
        if (m < MP) final_row(F, F.out + (size_t)m * D, kin(F, 23), F.out + (size_t)m * D);
        else { const int s = m - MP; final_row(F, (const float*)(F.ws + WS_XS) + (size_t)s * D, kin(F, 23), F.out + (size_t)MP * D + (size_t)s * D); }
    }
}

constexpr size_t O_YP = 0, O_YS = (size_t)MP * D, O_HP = O_YS + (size_t)NS * D, O_CP = O_HP + (size_t)DEPTH * NB * D, O_HS = O_CP + (size_t)DEPTH * NB * 3 * D,
                 O_CS = O_HS + (size_t)DEPTH * NS * D, O_VS = O_CS + (size_t)DEPTH * NS * 3 * D, O_END = O_VS + (size_t)DEPTH * NS * D;

__device__ __forceinline__ unsigned off_b(unsigned row, unsigned ch) { return 256u * row + 16u * (ch ^ (((row & 3) << 2) | ((row >> 2) & 3))); }
__device__ __forceinline__ unsigned tr_read_addr_16(unsigned lane, unsigned c, unsigned ks, unsigned t) {
    const unsigned g = lane >> 4, q = (lane & 15) >> 2, p = lane & 3;
    return off_b(32 * ks + 8 * g + 4 * t + q, 2 * c + (p >> 1)) + 8 * (p & 1);
}
typedef short v4i16_t __attribute__((ext_vector_type(4)));
__device__ __forceinline__ s16x4 vtr(LAS unsigned char* p) { return __builtin_bit_cast(s16x4, __builtin_amdgcn_ds_read_tr16_b64_v4i16((LAS v4i16_t*)p)); }

__device__ __forceinline__ void mixer_a_unit(Frame& F, int l, int a) {
    const int g = a & 7, bc = a >> 3;
    const int r0 = bc * CHUNK, c0 = g * 128;
    LAS unsigned char* vt = F.lds + RING_OFF;
    LAS float* rinv_s = (LAS float*)(F.lds + RING_OFF + 32768);
    const bf16* V = (const bf16*)(F.ws + WS_Z) + ZSTRIDE * 1; bf16* U = (bf16*)(F.ws + WS_Z); const bf16* GA = (const bf16*)(F.ws + WS_Z) + ZSTRIDE * 2;
    const float* vss = (const float*)(F.ws + WS_VSS);
    if (F.tid < 128) { const GAS f32x4* p = (const GAS f32x4*)(vss + (size_t)(r0 + F.tid) * 16); const f32x4 a0 = p[0], a1 = p[1], a2 = p[2], a3 = p[3];
        const float ss = ((a0.x + a0.y) + (a0.z + a0.w)) + ((a1.x + a1.y) + (a1.z + a1.w)) + ((a2.x + a2.y) + (a2.z + a2.w)) + ((a3.x + a3.y) + (a3.z + a3.w));
        rinv_s[F.tid] = 1.0f / sqrtf(ss * (1.f / D) + EPS); }
    __syncthreads();
    {
        const int ch = F.tid & 15; const float* gvp = kin(F, 10) + l * D + c0 + 8 * ch;
        const f32x4 g0 = *(const GAS f32x4*)gvp, g1 = *(const GAS f32x4*)(gvp + 4);
#pragma unroll
        for (int q = 0; q < 4; ++q) { const int s = (F.tid >> 4) + 32 * q; const v4u w = *(const GAS v4u*)(V + (size_t)(r0 + s) * D + c0 + 8 * ch); const float ri = rinv_s[s];
            v4u o; o.x = pk2(bfl(w.x) * ri * g0.x, bfh(w.x) * ri * g0.y); o.y = pk2(bfl(w.y) * ri * g0.z, bfh(w.y) * ri * g0.w);
            o.z = pk2(bfl(w.z) * ri * g1.x, bfh(w.z) * ri * g1.y); o.w = pk2(bfl(w.w) * ri * g1.z, bfh(w.w) * ri * g1.w);
            *(LAS v4u*)(vt + off_b(s, ch)) = o; }
    }
    __syncthreads();
    const int w = F.wave, fr = F.lane & 15, fq = F.lane >> 4, t = 16 * w + fr;
    const bf16* wsb = (const bf16*)(F.ws + WS_WSB) + ((size_t)(l * 8 + g) * 128 + t) * 128 + 8 * fq;
    pg8::f32x4 acc[8];
#pragma unroll
    for (int c = 0; c < 8; ++c) acc[c] = (pg8::f32x4){0.f, 0.f, 0.f, 0.f};
    const int nks = (w >> 1) + 1;
    for (int ks = 0; ks < nks; ++ks) {
        const bf16x8 wf = *(const GAS bf16x8*)(wsb + 32 * ks);
#pragma unroll
        for (int c = 0; c < 8; ++c) { const s16x4 lo = vtr(vt + tr_read_addr_16(F.lane, c, ks, 0)), hi = vtr(vt + tr_read_addr_16(F.lane, c, ks, 1));
            const bf16x8 vf = (bf16x8){lo[0], lo[1], lo[2], lo[3], hi[0], hi[1], hi[2], hi[3]};
            acc[c] = __builtin_amdgcn_mfma_f32_16x16x32_bf16(vf, wf, acc[c], 0, 0, 0); }
    }
    const float bs = kin(F, 12)[(l * 8 + g) * 128 + t];
    const size_t rowoff = (size_t)(r0 + t) * D + c0 + 4 * fq;
#pragma unroll
    for (int c = 0; c < 8; ++c) { const u32x2v uu = *(const GAS u32x2v*)(U + rowoff + 16 * c), gg = *(const GAS u32x2v*)(GA + rowoff + 16 * c);
        u32x2v o; o.x = pk2(bfl(uu.x) * bfl(gg.x) * (acc[c][0] + bs), bfh(uu.x) * bfh(gg.x) * (acc[c][1] + bs)); o.y = pk2(bfl(uu.y) * bfl(gg.y) * (acc[c][2] + bs), bfh(uu.y) * bfh(gg.y) * (acc[c][3] + bs));
        *(GAS u32x2v*)(U + rowoff + 16 * c) = o; }
    __syncthreads();
}

__device__ __forceinline__ void mixer_b_unit(Frame& F, int l, int bu) {
    const int b = bu >> 4, j = bu & 15, cb0 = 64 * j;
    LAS unsigned char* L = F.lds + RING_OFF;
    LAS unsigned char* xcb = L;
    LAS float* xx = (LAS float*)(L + 18432);
    LAS float* aa = (LAS float*)(L + 18432 + 32768);
    LAS float* prm = (LAS float*)(L + 18432 + 65536);
    LAS float* segP = prm + 512;
    LAS float* segH = segP + 512;
    LAS float* hcar = segH + 512;
    const bf16* XB = (const bf16*)(F.ws + WS_Z) + ZSTRIDE * 3; const bf16* GB = (const bf16*)(F.ws + WS_Z) + ZSTRIDE * 4; bf16* YB = (bf16*)(F.ws + WS_H);
    if (F.tid < 64) { const int c = l * D + cb0 + F.tid;
        prm[0 * 64 + F.tid] = kin(F, 13)[(l * 4 + 0) * D + cb0 + F.tid]; prm[1 * 64 + F.tid] = kin(F, 13)[(l * 4 + 1) * D + cb0 + F.tid];
        prm[2 * 64 + F.tid] = kin(F, 13)[(l * 4 + 2) * D + cb0 + F.tid]; prm[3 * 64 + F.tid] = kin(F, 13)[(l * 4 + 3) * D + cb0 + F.tid];
        prm[4 * 64 + F.tid] = kin(F, 14)[c]; prm[5 * 64 + F.tid] = kin(F, 16)[c]; prm[6 * 64 + F.tid] = kin(F, 18)[c];
        prm[7 * 64 + F.tid] = -8.0f * log1pf(__expf(-kin(F, 19)[c]));
        hcar[F.tid] = 0.f; }
    const int fr = F.lane & 15, fq = F.lane >> 4, w = F.wave;
    bf16x8 wfa[4][2], wfx[4][2];
    { const bf16* wa = (const bf16*)(F.ws + WS_WRA) + (size_t)(l * 16 + j) * 4096; const bf16* wx = (const bf16*)(F.ws + WS_WRX) + (size_t)(l * 16 + j) * 4096;
#pragma unroll
      for (int nt = 0; nt < 4; ++nt)
#pragma unroll
        for (int ks = 0; ks < 2; ++ks) { wfa[nt][ks] = *(const GAS bf16x8*)(wa + (16 * nt + fr) * 64 + 32 * ks + 8 * fq); wfx[nt][ks] = *(const GAS bf16x8*)(wx + (16 * nt + fr) * 64 + 32 * ks + 8 * fq); } }
    __syncthreads();
    const int trow = F.tid >> 2, part = F.tid & 3;
    const int jj = F.tid & 63, seg = F.tid >> 6;
    for (int ch = 0; ch < NCH; ++ch) {
        const int r0 = b * T + ch * CHUNK;
        {
            float xc[16];
#pragma unroll
            for (int e = 0; e < 16; ++e) xc[e] = prm[4 * 64 + 16 * part + e];
#pragma unroll
            for (int k = 0; k < 4; ++k) { const int tt = ch * CHUNK + trow - 3 + k;
                if (tt >= 0) { const GAS v4u* p = (const GAS v4u*)(XB + (size_t)(b * T + tt) * D + cb0 + 16 * part); const v4u w0 = p[0], w1 = p[1];
                    const LAS float* cw = prm + k * 64 + 16 * part;
                    xc[0] += cw[0] * bfl(w0.x); xc[1] += cw[1] * bfh(w0.x); xc[2] += cw[2] * bfl(w0.y); xc[3] += cw[3] * bfh(w0.y);
                    xc[4] += cw[4] * bfl(w0.z); xc[5] += cw[5] * bfh(w0.z); xc[6] += cw[6] * bfl(w0.w); xc[7] += cw[7] * bfh(w0.w);
                    xc[8] += cw[8] * bfl(w1.x); xc[9] += cw[9] * bfh(w1.x); xc[10] += cw[10] * bfl(w1.y); xc[11] += cw[11] * bfh(w1.y);
                    xc[12] += cw[12] * bfl(w1.z); xc[13] += cw[13] * bfh(w1.z); xc[14] += cw[14] * bfl(w1.w); xc[15] += cw[15] * bfh(w1.w); } }
            LAS float* xo = xx + trow * 64 + 16 * part;
#pragma unroll
            for (int e = 0; e < 16; e += 4) *(LAS f32x4*)(xo + e) = (f32x4){xc[e], xc[e + 1], xc[e + 2], xc[e + 3]};
            v4u o0, o1; o0.x = pk2(xc[0], xc[1]); o0.y = pk2(xc[2], xc[3]); o0.z = pk2(xc[4], xc[5]); o0.w = pk2(xc[6], xc[7]);
            o1.x = pk2(xc[8], xc[9]); o1.y = pk2(xc[10], xc[11]); o1.z = pk2(xc[12], xc[13]); o1.w = pk2(xc[14], xc[15]);
            *(LAS v4u*)(xcb + trow * 144 + 32 * part) = o0; *(LAS v4u*)(xcb + trow * 144 + 32 * part + 16) = o1;
        }
        __syncthreads();
        {
            const int t = 16 * w + fr;
            bf16x8 xf[2];
#pragma unroll
            for (int ks = 0; ks < 2; ++ks) xf[ks] = *(const LAS bf16x8*)(xcb + t * 144 + 64 * ks + 16 * fq);
#pragma unroll
            for (int nt = 0; nt < 4; ++nt) { pg8::f32x4 pa = (pg8::f32x4){0.f, 0.f, 0.f, 0.f}, px = pa;
#pragma unroll
                for (int ks = 0; ks < 2; ++ks) { pa = __builtin_amdgcn_mfma_f32_16x16x32_bf16(wfa[nt][ks], xf[ks], pa, 0, 0, 0); px = __builtin_amdgcn_mfma_f32_16x16x32_bf16(wfx[nt][ks], xf[ks], px, 0, 0, 0); }
                const int c4 = 16 * nt + 4 * fq;
                const f32x4 ba = *(const LAS f32x4*)(prm + 5 * 64 + c4), bx = *(const LAS f32x4*)(prm + 6 * 64 + c4), la = *(const LAS f32x4*)(prm + 7 * 64 + c4);
                const f32x4 xcv = *(const LAS f32x4*)(xx + t * 64 + c4);
                f32x4 av, xs;
#pragma unroll
                for (int e = 0; e < 4; ++e) { const float r = sigm(pa[e] + ba[e]), ig = sigm(px[e] + bx[e]); const float la_ = r * la[e];
                    av[e] = __expf(la_); xs[e] = sqrtf(-expm1f(2.0f * la_)) * (ig * xcv[e]); }
                *(LAS f32x4*)(aa + t * 64 + c4) = av; *(LAS f32x4*)(xx + t * 64 + c4) = xs; }
        }
        __syncthreads();
        {
            float av[16], xv[16]; float P = 1.f, Hh = 0.f;
#pragma unroll
            for (int i = 0; i < 16; ++i) { av[i] = aa[(16 * seg + i) * 64 + jj]; xv[i] = xx[(16 * seg + i) * 64 + jj]; Hh = av[i] * Hh + xv[i]; P *= av[i]; }
            segP[seg * 64 + jj] = P; segH[seg * 64 + jj] = Hh;
            __syncthreads();
            float h = hcar[jj];
            for (int s2 = 0; s2 < seg; ++s2) h = segP[s2 * 64 + jj] * h + segH[s2 * 64 + jj];
            const size_t go = (size_t)(r0 + 16 * seg) * D + cb0 + jj;
#pragma unroll
            for (int i = 0; i < 16; ++i) { h = av[i] * h + xv[i]; const float gb = bf1(GB[go + (size_t)i * D]); YB[go + (size_t)i * D] = (bf16)f2bf(h * gb); }
            __syncthreads();
            if (seg == 7) hcar[jj] = h;
        }
        __syncthreads();
    }
    if (F.tid < 64) { F.out[O_HP + ((size_t)l * NB + b) * D + cb0 + F.tid] = hcar[F.tid];
#pragma unroll
        for (int k = 0; k < 3; ++k) F.out[O_CP + (((size_t)l * NB + b) * 3 + k) * D + cb0 + F.tid] = bf1(XB[(size_t)(b * T + T - 3 + k) * D + cb0 + F.tid]); }
    __syncthreads();
}

__device__ __forceinline__ void mixer_s_unit(Frame& F, int l, int s) {
    LAS float* xcs = (LAS float*)(F.lds + RING_OFF);
    LAS float* redl = xcs + 1024;
    const float* z = (const float*)(F.ws + WS_ZS) + (size_t)s * DIN;
    float vv[2]; float ss = 0.f;
#pragma unroll
    for (int q = 0; q < 2; ++q) { vv[q] = z[D + F.tid + 512 * q]; ss += vv[q] * vv[q]; }
    ss = wave_sum(ss); if (F.lane == 0) redl[F.wave] = ss;
    __syncthreads();
    float tot = 0.f;
#pragma unroll
    for (int w = 0; w < 8; ++w) tot += redl[w];
    const float rinv = 1.0f / sqrtf(tot * (1.f / D) + EPS);
    float xcv[2];
#pragma unroll
    for (int q = 0; q < 2; ++q) { const int c = F.tid + 512 * q, g = c >> 7;
        const float vn = vv[q] * rinv * kin(F, 10)[l * D + c];
        F.out[O_VS + ((size_t)l * NS + s) * D + c] = vn;
        const float sg = kin(F, 11)[(size_t)(l * 8 + g) * 128 * 128] * vn + kin(F, 12)[(l * 8 + g) * 128];
        const float ya = z[c] * sg * siluf(z[2 * D + c]);
        ((bf16*)(F.ws + WS_YAS))[(size_t)s * D + c] = (bf16)f2bf(ya);
        const float* cbuf = kin(F, 5) + ((size_t)(l * NS + s) * 3) * D + c; const float b0 = cbuf[0], b1 = cbuf[D], b2 = cbuf[2 * D], xb = z[3 * D + c];
        const float* cw = kin(F, 13) + (size_t)l * 4 * D + c;
        const float xc = kin(F, 14)[l * D + c] + cw[0] * b0 + cw[D] * b1 + cw[2 * D] * b2 + cw[3 * D] * xb;
        float* co = F.out + O_CS + ((size_t)(l * NS + s) * 3) * D + c; co[0] = b1; co[D] = b2; co[2 * D] = xb;
        xcs[c] = xc; xcv[q] = xc; }
    __syncthreads();
#pragma unroll
    for (int q = 0; q < 2; ++q) { const int c = F.tid + 512 * q, h = c >> 6, j = c & 63;
        const float* wa = kin(F, 15) + (size_t)(l * 16 + h) * 4096 + j; const float* wx = kin(F, 17) + (size_t)(l * 16 + h) * 4096 + j;
        float ra = 0.f, rx = 0.f;
#pragma unroll 8
        for (int i = 0; i < 64; ++i) { const float x = xcs[64 * h + i]; ra += x * wa[i * 64]; rx += x * wx[i * 64]; }
        const float r = sigm(ra + kin(F, 16)[l * D + c]), ig = sigm(rx + kin(F, 18)[l * D + c]);
        const float la = -8.0f * r * log1pf(__expf(-kin(F, 19)[l * D + c]));
        const float a = __expf(la), mult = sqrtf(-expm1f(2.0f * la));
        const float h0 = kin(F, 4)[((size_t)l * NS + s) * D + c];
        const float hn = a * h0 + mult * (ig * xcv[q]);
        F.out[O_HS + ((size_t)l * NS + s) * D + c] = hn;
        ((bf16*)(F.ws + WS_YBS))[(size_t)s * D + c] = (bf16)f2bf(hn * siluf(z[4 * D + c])); }
    __syncthreads();
}

__device__ __forceinline__ void p_mixer(Frame& F, int l) {
    phase_begin(F);
    if (F.G > 128) {
        if (F.vcu < 128) mixer_b_unit(F, l, F.vcu);
        else { const int idx = F.vcu - 128, stride = F.G - 128;
            for (int a = idx; a < 1024 + NS; a += stride) { if (a < 1024) mixer_a_unit(F, l, a); else mixer_s_unit(F, l, a - 1024); } }
    } else {
        for (int bu = F.vcu; bu < 128; bu += F.G) mixer_b_unit(F, l, bu);
        for (int a = F.vcu; a < 1024 + NS; a += F.G) { if (a < 1024) mixer_a_unit(F, l, a); else mixer_s_unit(F, l, a - 1024); }
    }
}


struct Args { const float* in[24]; float* out; unsigned char* ws; int ph_lo, ph_hi; };
__global__ void __launch_bounds__(NWAVES * 64, 2) mk_fwd(Args args) {
    extern __shared__ __attribute__((aligned(16))) unsigned char lds[];
    Frame F;
    F.lds = (LAS unsigned char*)lds;
    F.MISC = (volatile LAS unsigned*)(F.lds + MISC_OFF);
    F.tid = threadIdx.x; F.lane = F.tid & 63; F.wave = __builtin_amdgcn_readfirstlane(F.tid >> 6);
    F.G = gridDim.x; { const int bx = blockIdx.x; F.vcu = (F.G % 8 == 0) ? (bx % 8) * (F.G / 8) + bx / 8 : bx; }
    F.ka = (kq_t*)__builtin_amdgcn_kernarg_segment_ptr();
    F.out = args.out; F.ws = args.ws;
    for (int u = F.tid; u < (LDS_BYTES - LDSCTL_OFF) / 4; u += NWAVES * 64) ((LAS unsigned*)(F.lds + LDSCTL_OFF))[u] = 0u;
    __syncthreads();
    XcdBarrier bar; bar.bar = (unsigned*)((gu32*)(args.ws + WS_CTL) + CW_BAR); bar.x = 0; bar.st = nullptr;
    if (MK_ONE_LAUNCH) bar = xcd_barrier_post((unsigned*)((gu32*)(args.ws + WS_CTL) + CW_BAR), F.MISC + 8);
    const int lo = args.ph_lo, hi = args.ph_hi;
#define IN(k) (lo <= (k) && (k) < hi)
#define SEAM(k) do { if (MK_ONE_LAUNCH && IN(k) && IN((k) + 1)) xcd_barrier(bar); } while (0)
#define Zb ((bf16*)(F.ws + WS_Z))
#define MOD ((float*)(F.ws + WS_MOD))

    if (IN(0)) p0_convert(F);
    SEAM(0);
    if (IN(1)) { EpiMod E{MOD, kin(F, 7)}; skinny_gemm<10, false, EpiMod>(F, (const bf16*)(F.ws + WS_SC), (const bf16*)(F.ws + WS_WADA), nullptr, nullptr, DEPTH * 3 * D, E); }
    SEAM(1);
    for (int l = 0; l < DEPTH; ++l) {
        const int p = 2 + 5 * l;
        if (IN(p)) p_norm(F, l);
        SEAM(p);
        if (IN(p + 1)) {
            pg8::Gemm g{(const bf16*)(F.ws + WS_H), (const bf16*)(F.ws + WS_WIN) + (size_t)l * DIN * D, MP, DIN, D}; pg8::StaticOrder S; S.init(MP, DIN, F.G, (int)blockIdx.x);
            pg8::Epi1 E{Zb, ZSTRIDE, (float*)(F.ws + WS_VSS)};
            pg8::gemm_phase<pg8::Epi1, pg8::StaticOrder, PG8_ALIGN, PG8_SP2>(F.lds + RING_OFF, g, S, E);
            EpiZs Es{(float*)(F.ws + WS_ZS)};
            skinny_gemm<8, false, EpiZs>(F, (const bf16*)(F.ws + WS_HS), (const bf16*)(F.ws + WS_WIN) + (size_t)l * DIN * D, nullptr, nullptr, DIN, Es);
        }
        SEAM(p + 1);
        if (IN(p + 2)) p_mixer(F, l);
        SEAM(p + 2);
        if (IN(p + 3)) {
            bf16* const MG = Zb + ZSTRIDE * 1;
            { pg8::Gemm g{Zb, (const bf16*)(F.ws + WS_WPA) + (size_t)l * D * D, MP, D, D}; pg8::StaticOrder S; S.init(MP, D, F.G, (int)blockIdx.x);
              pg8::Epi2<false> E{Zb + ZSTRIDE * 5, MG};
              pg8::gemm_phase<pg8::Epi2<false>, pg8::StaticOrder, PG8_ALIGN, PG8_SP2>(F.lds + RING_OFF, g, S, E); }
            { pg8::Gemm g{(const bf16*)(F.ws + WS_H), (const bf16*)(F.ws + WS_WPB) + (size_t)l * D * D, MP, D, D}; pg8::StaticOrder S; S.init(MP, D, F.G, (int)blockIdx.x);
              pg8::Epi2<true> E{Zb + ZSTRIDE * 6, MG};
              pg8::gemm_phase<pg8::Epi2<true>, pg8::StaticOrder, PG8_ALIGN, PG8_SP2>(F.lds + RING_OFF, g, S, E); }
            EpiMs Es{(const float*)(F.ws + WS_ZS), (bf16*)(F.ws + WS_MS)};
            skinny_gemm<8, true, EpiMs>(F, (const bf16*)(F.ws + WS_YAS), (const bf16*)(F.ws + WS_WPA) + (size_t)l * D * D, (const bf16*)(F.ws + WS_YBS), (const bf16*)(F.ws + WS_WPB) + (size_t)l * D * D, D, Es);
        }
        SEAM(p + 3);
        if (IN(p + 4)) {
            pg8::Gemm g{Zb + ZSTRIDE * 1, (const bf16*)(F.ws + WS_WOUT) + (size_t)l * D * D, MP, D, D}; pg8::StaticOrder S; S.init(MP, D, F.G, (int)blockIdx.x);
            pg8::Epi3 E{l == 0 ? kin(F, 0) : F.out, F.out, MOD + (size_t)l * NBS * 3 * D + 2 * D};
            pg8::gemm_phase<pg8::Epi3, pg8::StaticOrder, PG8_ALIGN, PG8_SP2>(F.lds + RING_OFF, g, S, E);
            EpiXs Es{l == 0 ? kin(F, 1) : (const float*)(F.ws + WS_XS), (float*)(F.ws + WS_XS), MOD + ((size_t)l * NBS + NB) * 3 * D + 2 * D};
            skinny_gemm<8, false, EpiXs>(F, (const bf16*)(F.ws + WS_MS), (const bf16*)(F.ws + WS_WOUT) + (size_t)l * D * D, nullptr, nullptr, D, Es);
        }
        SEAM(p + 4);
    }
    if (IN(NPH - 1)) p_final(F);
#undef IN
#undef SEAM
#undef Zb
#undef MOD
}

extern "C" void kernel_launch(void* const* d_in, const int* in_sizes, int n_in, void* d_out, int out_size, void* d_ws, size_t ws_size, hipStream_t stream) {
    static int grid = 0;
    if (grid == 0) {
        if (n_in != 24 || in_sizes[0] != MP * D || (size_t)out_size != O_END || ws_size < WS_END) { fprintf(stderr, "kernel_launch: unexpected shapes: n_in %d in0 %d out %d ws %zu (need %zu)\n", n_in, n_in > 0 ? in_sizes[0] : -1, out_size, ws_size, (size_t)WS_END); grid = -1; return; }
        int dev = 0, cus = 0, per_cu = 0;
        if (hipGetDevice(&dev) != hipSuccess || hipDeviceGetAttribute(&cus, hipDeviceAttributeMultiprocessorCount, dev) != hipSuccess) { fprintf(stderr, "kernel_launch: device query failed\n"); grid = -1; return; }
        if (hipFuncSetAttribute((const void*)mk_fwd, hipFuncAttributeMaxDynamicSharedMemorySize, LDS_BYTES) != hipSuccess) { fprintf(stderr, "kernel_launch: hipFuncSetAttribute failed\n"); grid = -1; return; }
        if (hipOccupancyMaxActiveBlocksPerMultiprocessor(&per_cu, (const void*)mk_fwd, NWAVES * 64, LDS_BYTES) != hipSuccess || per_cu < 1) { fprintf(stderr, "kernel_launch: occupancy query says %d blocks per CU\n", per_cu); (void)hipGetLastError(); grid = -1; return; }
        grid = cus;
        if (grid > 256) grid = 256;
        if (grid != 256) fprintf(stderr, "kernel_launch: %d CUs; built and tuned for 256\n", cus);
    }
    if (grid < 0) return;
    if (hipMemsetAsync((char*)d_ws + WS_CTL, 0, CTL_ZERO_BYTES, stream) != hipSuccess) { fprintf(stderr, "kernel_launch: memset failed\n"); return; }
    Args a{};
    for (int i = 0; i < 24; ++i) a.in[i] = (const float*)d_in[i];
    a.out = (float*)d_out; a.ws = (unsigned char*)d_ws;
#if MK_ONE_LAUNCH
    a.ph_lo = 0; a.ph_hi = NPH;
    hipLaunchKernelGGL(mk_fwd, dim3(grid), dim3(NWAVES * 64), LDS_BYTES, stream, a);
#else
    for (int p = 0; p < NPH; ++p) { a.ph_lo = p; a.ph_hi = p + 1; hipLaunchKernelGGL(mk_fwd, dim3(grid), dim3(NWAVES * 64), LDS_BYTES, stream, a); }
#endif
    const hipError_t le = hipPeekAtLastError();
    if (le != hipSuccess) fprintf(stderr, "kernel_launch: launch failed: %s\n", hipGetErrorName(le));
}
```
